# Optimizing an MI355X kernel written in HIP

```python
import jax, jax.numpy as jnp
from jax import lax
import numpy as np

D_MODEL = 1024
BATCH = 8
SEQ = 2048
DEPTH = 2
DEC_BATCH = 128
DEC_SEQ = 1
PAST_LEN = 2048
PAGE_SIZE = 128

D_MIX = D_MODEL
HEAD_DIM = 64
GROUP_W = D_MIX // 4
C_A = GROUP_W
CONV_A_W = 31
H_B = GROUP_W // HEAD_DIM
DV_B = HEAD_DIM
DK_B = HEAD_DIM // 2
GLA_RANK = 16
GLA_TAU = 16.0
GLA_CHUNK = 64
C_C = GROUP_W
CONV_C_W = 3
H_D = GROUP_W // HEAD_DIM
DH_D = HEAD_DIM
Q_BLOCK = 128
FORGET_BIAS_INIT = 3.0
D_FF = ((8 * D_MODEL // 3 + 127) // 128) * 128
EPS = 1e-6
NEG_INF = -1e30

OFF_A = 0
N_A = 2 * C_A
OFF_B = OFF_A + N_A
N_B = 2 * H_B * DK_B + 2 * H_B * DV_B + GLA_RANK
OFF_C = OFF_B + N_B
N_C = 3 * C_C
OFF_D = OFF_C + N_C
N_D = 3 * H_D * DH_D + H_D
N_IN = OFF_D + N_D

kernel_name = 'hymba_style_conformer_gla_shortconv_fox_decoder_step'

F32 = jnp.float32


def rms_norm(x, g):
    xf = x.astype(F32)
    y = xf * lax.rsqrt(jnp.mean(xf * xf, axis=-1, keepdims=True) + EPS)
    return (y * g.astype(F32)).astype(x.dtype)


def layer_norm(x, g, b):
    xf = x.astype(F32)
    mu = jnp.mean(xf, axis=-1, keepdims=True)
    var = jnp.mean(jnp.square(xf - mu), axis=-1, keepdims=True)
    y = (xf - mu) * lax.rsqrt(var + EPS) * g.astype(F32) + b.astype(F32)
    return y.astype(x.dtype)


def swiglu(x, w_gate, w_up, w_down):
    return (jax.nn.silu(x @ w_gate) * (x @ w_up)) @ w_down


def causal_depthwise(xpad, w):
    c = xpad.shape[-1]
    return lax.conv_general_dilated(xpad, w.astype(xpad.dtype)[:, None, :], window_strides=(1,),
                                    padding='VALID', dimension_numbers=('NWC', 'WIO', 'NWC'),
                                    feature_group_count=c)


def conformer_conv(pa, buf, conv_w, conv_b, ln_g, ln_b):
    val, gate = jnp.split(pa, 2, axis=-1)
    a = val * jax.nn.sigmoid(gate)
    xpad = jnp.concatenate([buf.astype(a.dtype), a], axis=1)
    y = causal_depthwise(xpad, conv_w) + conv_b.astype(a.dtype)
    y = jax.nn.silu(layer_norm(y, ln_g, ln_b))
    return y, xpad[:, -(CONV_A_W - 1):]


def gla_chunked(q, k, v, log_a, s0, chunk):
    bsz, length, nh, dk = q.shape
    n = length // chunk

    def to_chunks(t):
        return t.reshape(bsz, n, chunk, *t.shape[2:]).swapaxes(0, 1)

    mask = jnp.tril(jnp.ones((chunk, chunk), bool))[None, :, :, None, None]

    def step(s, inp):
        qc, kc, vc, ac = inp
        b = jnp.cumsum(ac, axis=1)
        o_inter = jnp.einsum('bthk,bhkv->bthv', qc * jnp.exp(b), s)
        diff = b[:, :, None] - b[:, None, :]
        decay = jnp.exp(jnp.where(mask, diff, -jnp.inf))
        scores = jnp.einsum('bthk,bshk,btshk->bhts', qc, kc, decay)
        o_intra = jnp.einsum('bhts,bshv->bthv', scores, vc)
        b_last = b[:, -1]
        k_dec = kc * jnp.exp(b_last[:, None] - b)
        s_new = jnp.exp(b_last)[..., None] * s + jnp.einsum('bshk,bshv->bhkv', k_dec, vc)
        return s_new, o_inter + o_intra

    s_fin, o = lax.scan(step, s0, (to_chunks(q), to_chunks(k), to_chunks(v), to_chunks(log_a)))
    return o.swapaxes(0, 1).reshape(bsz, length, nh, v.shape[-1]), s_fin


def gla_mixer(pb, state, w_a2, b_a, norm_g):
    bsz, length, _ = pb.shape
    kd, vd = H_B * DK_B, H_B * DV_B
    q, k, v, g, a_lr = jnp.split(pb, [kd, 2 * kd, 2 * kd + vd, 2 * kd + 2 * vd], axis=-1)
    log_a = jax.nn.log_sigmoid((a_lr @ w_a2 + b_a).astype(F32)) / GLA_TAU
    q = q.astype(F32).reshape(bsz, length, H_B, DK_B) * (DK_B ** -0.5)
    k = k.astype(F32).reshape(bsz, length, H_B, DK_B)
    v = v.astype(F32).reshape(bsz, length, H_B, DV_B)
    log_a = log_a.reshape(bsz, length, H_B, DK_B)
    chunk = GLA_CHUNK if length % GLA_CHUNK == 0 else length
    o, s_new = gla_chunked(q, k, v, log_a, state.astype(F32), chunk)
    o = o * lax.rsqrt(jnp.mean(o * o, axis=-1, keepdims=True) + EPS)
    o = o.reshape(bsz, length, vd) * norm_g.astype(F32)
    y = o * jax.nn.silu(g.astype(F32))
    return y.astype(pb.dtype), s_new


def short_conv(pc, buf, conv_w):
    bg, cg, xv = jnp.split(pc, 3, axis=-1)
    z = cg * xv
    zpad = jnp.concatenate([buf.astype(z.dtype), z], axis=1)
    y = bg * causal_depthwise(zpad, conv_w)
    return y, zpad[:, -(CONV_C_W - 1):]


def fox_project(pd, b_f):
    bsz, length, _ = pd.shape
    hd = H_D * DH_D
    q = pd[..., :hd].reshape(bsz, length, H_D, DH_D)
    k = pd[..., hd:2 * hd].reshape(bsz, length, H_D, DH_D)
    v = pd[..., 2 * hd:3 * hd].reshape(bsz, length, H_D, DH_D)
    logf = jax.nn.log_sigmoid((pd[..., 3 * hd:] + b_f).astype(F32))
    return q, k, v, logf


def fox_prompt(q, k, v, logf):
    bsz, length, nh, dh = q.shape
    nb = length // Q_BLOCK
    c_keys = jnp.cumsum(logf, axis=1).transpose(0, 2, 1)
    q_blocks = q.reshape(bsz, nb, Q_BLOCK, nh, dh).swapaxes(0, 1)
    c_blocks = c_keys.reshape(bsz, nh, nb, Q_BLOCK).transpose(2, 0, 1, 3)
    k_pos = jnp.arange(length)
    scale = dh ** -0.5

    def one_block(args):
        blk, qb, cb = args
        s = jnp.einsum('bqhd,bkhd->bhqk', qb, k).astype(F32) * scale
        s = s + cb[..., :, None] - c_keys[:, :, None, :]
        q_pos = blk * Q_BLOCK + jnp.arange(Q_BLOCK)
        s = jnp.where(k_pos[None, :] <= q_pos[:, None], s, NEG_INF)
        p = jax.nn.softmax(s, axis=-1).astype(v.dtype)
        return jnp.einsum('bhqk,bkhd->bqhd', p, v)

    o = lax.map(one_block, (jnp.arange(nb), q_blocks, c_blocks))
    return o.swapaxes(0, 1).reshape(bsz, length, nh * dh)


def fox_decode(q, k, v, logf, k_past, v_past, logf_past):
    bsz, t_new, nh, dh = q.shape
    p_len = k_past.shape[1]
    scale = dh ** -0.5
    c_past = jnp.cumsum(logf_past.astype(F32), axis=1)
    c_new = jnp.cumsum(logf, axis=1).transpose(0, 2, 1)
    tail = (c_past[:, -1:] - c_past).transpose(0, 2, 1)
    bias_past = c_new[..., :, None] + tail[:, :, None, :]
    bias_new = c_new[..., :, None] - c_new[..., None, :]
    causal = jnp.tril(jnp.ones((t_new, t_new), bool))
    s_past = jnp.einsum('bthd,bshd->bhts', q, k_past.astype(q.dtype)).astype(F32) * scale + bias_past
    s_new = jnp.einsum('bthd,bshd->bhts', q, k).astype(F32) * scale + bias_new
    s_new = jnp.where(causal, s_new, NEG_INF)
    p = jax.nn.softmax(jnp.concatenate([s_past, s_new], axis=-1), axis=-1).astype(v.dtype)
    o = (jnp.einsum('bhts,bshd->bthd', p[..., :p_len], v_past.astype(v.dtype))
         + jnp.einsum('bhts,bshd->bthd', p[..., p_len:], v))
    return o.reshape(bsz, t_new, nh * dh)


def decoder_layer(x, lw, conv_a_buf, gla_state, conv_c_buf, fox_past):
    (f1_pre, f1_post, f1_wg, f1_wu, f1_wd, m_pre, m_post, w_in, w_out,
     a_cw, a_cb, a_lg, a_lb, b_wa2, b_ba, b_ng, c_cw, d_bf,
     f2_pre, f2_post, f2_wg, f2_wu, f2_wd) = lw
    bsz, length, _ = x.shape
    h = x + 0.5 * rms_norm(swiglu(rms_norm(x, f1_pre), f1_wg, f1_wu, f1_wd), f1_post)
    u = rms_norm(h, m_pre)
    p_all = u @ w_in
    ya, buf_a = conformer_conv(p_all[..., OFF_A:OFF_B], conv_a_buf, a_cw, a_cb, a_lg, a_lb)
    yb, s_b = gla_mixer(p_all[..., OFF_B:OFF_C], gla_state, b_wa2, b_ba, b_ng)
    yc, buf_c = short_conv(p_all[..., OFF_C:OFF_D], conv_c_buf, c_cw)
    q, k, v, logf = fox_project(p_all[..., OFF_D:N_IN], d_bf)
    if fox_past is None:
        yd = fox_prompt(q, k, v, logf)
    else:
        yd = fox_decode(q, k, v, logf, fox_past[0], fox_past[1], fox_past[2])
    y = jnp.concatenate([ya, yb, yc, yd], axis=-1) @ w_out
    h = h + rms_norm(y, m_post)
    h = h + 0.5 * rms_norm(swiglu(rms_norm(h, f2_pre), f2_wg, f2_wu, f2_wd), f2_post)
    return h, (buf_a, s_b, buf_c, k, v, logf)


def setup_inputs(seed: int = 0) -> dict:
    key = jax.random.key(seed)
    ks = jax.random.split(key, 40)
    n_pages = PAST_LEN // PAGE_SIZE
    n_used = DEC_BATCH * n_pages
    n_pool = n_used + max(1, n_used // 4)

    def nrm(k, shape, scale):
        return scale * jax.random.normal(k, shape, F32)

    def gain(k, shape):
        return 1.0 + 0.05 * jax.random.normal(k, shape, F32)

    page_table = jax.random.permutation(ks[8], n_pool)[:n_used].reshape(DEC_BATCH, n_pages).astype(jnp.int32)
    return {
        'x_prompt': nrm(ks[0], (BATCH, SEQ, D_MODEL), 1.0),
        'x_sample': nrm(ks[1], (DEC_BATCH, DEC_SEQ, D_MODEL), 1.0),
        'state_conv_a': nrm(ks[2], (DEPTH, DEC_BATCH, CONV_A_W - 1, C_A), 0.5),
        'state_gla': nrm(ks[3], (DEPTH, DEC_BATCH, H_B, DK_B, DV_B), 0.5),
        'state_conv_c': nrm(ks[4], (DEPTH, DEC_BATCH, CONV_C_W - 1, C_C), 0.5),
        'cache_k': nrm(ks[5], (DEPTH, n_pool, PAGE_SIZE, H_D, DH_D), 1.0),
        'cache_v': nrm(ks[6], (DEPTH, n_pool, PAGE_SIZE, H_D, DH_D), 1.0),
        'cache_logf': jax.nn.log_sigmoid(FORGET_BIAS_INIT + jax.random.normal(ks[7], (DEPTH, n_pool, PAGE_SIZE, H_D), F32)),
        'page_table': page_table,
        'ffn1_pre_g': gain(ks[9], (DEPTH, D_MODEL)),
        'ffn1_post_g': gain(ks[10], (DEPTH, D_MODEL)),
        'ffn1_w_gate': nrm(ks[11], (DEPTH, D_MODEL, D_FF), D_MODEL ** -0.5),
        'ffn1_w_up': nrm(ks[12], (DEPTH, D_MODEL, D_FF), D_MODEL ** -0.5),
        'ffn1_w_down': nrm(ks[13], (DEPTH, D_FF, D_MODEL), D_FF ** -0.5),
        'mix_pre_g': gain(ks[14], (DEPTH, D_MODEL)),
        'mix_post_g': gain(ks[15], (DEPTH, D_MODEL)),
        'w_in': nrm(ks[16], (DEPTH, D_MODEL, N_IN), D_MODEL ** -0.5),
        'w_out': nrm(ks[17], (DEPTH, D_MIX, D_MODEL), D_MIX ** -0.5),
        'a_conv_w': nrm(ks[18], (DEPTH, CONV_A_W, C_A), CONV_A_W ** -0.5),
        'a_conv_b': nrm(ks[19], (DEPTH, C_A), 0.02),
        'a_ln_g': gain(ks[20], (DEPTH, C_A)),
        'a_ln_b': nrm(ks[21], (DEPTH, C_A), 0.02),
        'b_gate_w2': nrm(ks[22], (DEPTH, GLA_RANK, H_B * DK_B), GLA_RANK ** -0.5),
        'b_gate_b': nrm(ks[23], (DEPTH, H_B * DK_B), 0.1),
        'b_out_norm_g': gain(ks[24], (DEPTH, H_B * DV_B)),
        'c_conv_w': nrm(ks[25], (DEPTH, CONV_C_W, C_C), CONV_C_W ** -0.5),
        'd_forget_b': FORGET_BIAS_INIT + nrm(ks[26], (DEPTH, H_D), 0.1),
        'ffn2_pre_g': gain(ks[27], (DEPTH, D_MODEL)),
        'ffn2_post_g': gain(ks[28], (DEPTH, D_MODEL)),
        'ffn2_w_gate': nrm(ks[29], (DEPTH, D_MODEL, D_FF), D_MODEL ** -0.5),
        'ffn2_w_up': nrm(ks[30], (DEPTH, D_MODEL, D_FF), D_MODEL ** -0.5),
        'ffn2_w_down': nrm(ks[31], (DEPTH, D_FF, D_MODEL), D_FF ** -0.5),
    }


def reference(x_prompt, x_sample, state_conv_a, state_gla, state_conv_c, cache_k, cache_v, cache_logf,
              page_table, ffn1_pre_g, ffn1_post_g, ffn1_w_gate, ffn1_w_up, ffn1_w_down, mix_pre_g,
              mix_post_g, w_in, w_out, a_conv_w, a_conv_b, a_ln_g, a_ln_b, b_gate_w2, b_gate_b,
              b_out_norm_g, c_conv_w, d_forget_b, ffn2_pre_g, ffn2_post_g, ffn2_w_gate, ffn2_w_up,
              ffn2_w_down):
    bp = x_prompt.shape[0]
    bd = page_table.shape[0]
    hp, hs = x_prompt, x_sample
    p_ca, p_gla, p_cc, p_k, p_v, p_lf = [], [], [], [], [], []
    s_ca, s_gla, s_cc, s_k, s_v, s_lf = [], [], [], [], [], []
    for l in range(DEPTH):
        lw = (ffn1_pre_g[l], ffn1_post_g[l], ffn1_w_gate[l], ffn1_w_up[l], ffn1_w_down[l],
              mix_pre_g[l], mix_post_g[l], w_in[l], w_out[l],
              a_conv_w[l], a_conv_b[l], a_ln_g[l], a_ln_b[l],
              b_gate_w2[l], b_gate_b[l], b_out_norm_g[l], c_conv_w[l], d_forget_b[l],
              ffn2_pre_g[l], ffn2_post_g[l], ffn2_w_gate[l], ffn2_w_up[l], ffn2_w_down[l])
        hp, st = decoder_layer(
            hp, lw,
            jnp.zeros((bp, CONV_A_W - 1, C_A), hp.dtype),
            jnp.zeros((bp, H_B, DK_B, DV_B), F32),
            jnp.zeros((bp, CONV_C_W - 1, C_C), hp.dtype),
            None)
        p_ca.append(st[0]); p_gla.append(st[1]); p_cc.append(st[2])
        p_k.append(st[3]); p_v.append(st[4]); p_lf.append(st[5])
        k_past = cache_k[l][page_table].reshape(bd, -1, H_D, DH_D)
        v_past = cache_v[l][page_table].reshape(bd, -1, H_D, DH_D)
        lf_past = cache_logf[l][page_table].reshape(bd, -1, H_D)
        hs, st = decoder_layer(hs, lw, state_conv_a[l], state_gla[l], state_conv_c[l],
                               (k_past, v_past, lf_past))
        s_ca.append(st[0]); s_gla.append(st[1]); s_cc.append(st[2])
        s_k.append(st[3]); s_v.append(st[4]); s_lf.append(st[5])
    return (hp, hs,
            jnp.stack(p_ca), jnp.stack(p_gla), jnp.stack(p_cc), jnp.stack(p_k), jnp.stack(p_v), jnp.stack(p_lf),
            jnp.stack(s_ca), jnp.stack(s_gla), jnp.stack(s_cc), jnp.stack(s_k), jnp.stack(s_v), jnp.stack(s_lf))
```

```cpp
#include <hip/hip_runtime.h>
#include <cstdint>
#include <cstddef>

constexpr int DM = 1024, NB = 8, SEQ = 2048, DEPTH = 2, DB = 128, PAST = 2048, PAGE = 128, NPAGES = PAST / PAGE;
constexpr int NPOOL = DB * NPAGES + (DB * NPAGES) / 4;
constexpr int MP = NB * SEQ, MS = DB, MT = MP + MS;
constexpr int CA = 256, CW_A = 31, HB = 4, DVB = 64, DKB = 32, RANK = 16, CC = 256, HD = 4, DHD = 64;
constexpr int DFF = 2816;
constexpr int OFF_A = 0, N_A = 512, OFF_B = 512, N_B = 784, OFF_C = 1296, N_C = 768, OFF_D = 2064, N_D = 772, N_IN = 2836;
constexpr float EPS = 1e-6f;

constexpr size_t O_YP = 0, O_YS = O_YP + (size_t)MP * DM, O_PCA = O_YS + (size_t)MS * DM, O_PGLA = O_PCA + (size_t)DEPTH * NB * 30 * CA,
    O_PCC = O_PGLA + (size_t)DEPTH * NB * HB * DKB * DVB, O_PK = O_PCC + (size_t)DEPTH * NB * 2 * CC, O_PV = O_PK + (size_t)DEPTH * MP * 256,
    O_PLF = O_PV + (size_t)DEPTH * MP * 256, O_SCA = O_PLF + (size_t)DEPTH * MP * 4, O_SGLA = O_SCA + (size_t)DEPTH * DB * 30 * CA,
    O_SCC = O_SGLA + (size_t)DEPTH * DB * HB * DKB * DVB, O_SK = O_SCC + (size_t)DEPTH * DB * 2 * CC, O_SV = O_SK + (size_t)DEPTH * DB * 256,
    O_SLF = O_SV + (size_t)DEPTH * DB * 256, O_END = O_SLF + (size_t)DEPTH * DB * 4;

__device__ __forceinline__ float sigmoidf_(float x) { return 1.0f / (1.0f + __expf(-x)); }
__device__ __forceinline__ float siluf_(float x) { return x / (1.0f + __expf(-x)); }
__device__ __forceinline__ float logsigmoidf_(float x) { return fminf(x, 0.f) - log1pf(__expf(-fabsf(x))); }

__global__ void __launch_bounds__(256) gemm_f32(const float* __restrict__ A, int lda, const float* __restrict__ B, int ldb, float* __restrict__ C, int ldc, int M, int N, int K) {
    __shared__ float sA[16][64 + 4];
    __shared__ float sB[16][64 + 4];
    const int tx = threadIdx.x & 15, ty = threadIdx.x >> 4;
    const int m0 = blockIdx.y * 64, n0 = blockIdx.x * 64;
    float acc[4][4] = {};
    for (int k0 = 0; k0 < K; k0 += 16) {
        for (int e = threadIdx.x; e < 64 * 16; e += 256) {
            const int r = e >> 4, c = e & 15;
            sA[c][r] = A[(size_t)(m0 + r) * lda + k0 + c];
        }
        for (int e = threadIdx.x; e < 16 * 64; e += 256) {
            const int r = e >> 6, c = e & 63;
            sB[r][c] = (n0 + c < N) ? B[(size_t)(k0 + r) * ldb + n0 + c] : 0.f;
        }
        __syncthreads();
#pragma unroll
        for (int k = 0; k < 16; ++k) {
            float a[4], b[4];
#pragma unroll
            for (int i = 0; i < 4; ++i) { a[i] = sA[k][ty * 4 + i]; b[i] = sB[k][tx * 4 + i]; }
#pragma unroll
            for (int i = 0; i < 4; ++i)
#pragma unroll
                for (int j = 0; j < 4; ++j) acc[i][j] += a[i] * b[j];
        }
        __syncthreads();
    }
#pragma unroll
    for (int i = 0; i < 4; ++i)
#pragma unroll
        for (int j = 0; j < 4; ++j) { const int n = n0 + tx * 4 + j; if (n < N) C[(size_t)(m0 + ty * 4 + i) * ldc + n] = acc[i][j]; }
}

__device__ __forceinline__ float block_sum_256(float v, float* red) {
#pragma unroll
    for (int o = 32; o > 0; o >>= 1) v += __shfl_xor(v, o);
    __syncthreads();
    if ((threadIdx.x & 63) == 0) red[threadIdx.x >> 6] = v;
    __syncthreads();
    return red[0] + red[1] + red[2] + red[3];
}
__global__ void __launch_bounds__(256) rmsnorm_rows(const float* __restrict__ X, const float* __restrict__ g, float* __restrict__ O) {
    __shared__ float red[4];
    const size_t row = blockIdx.x;
    float v[4], s = 0.f;
#pragma unroll
    for (int i = 0; i < 4; ++i) { v[i] = X[row * DM + threadIdx.x + 256 * i]; s += v[i] * v[i]; }
    s = block_sum_256(s, red);
    const float r = rsqrtf(s * (1.0f / DM) + EPS);
#pragma unroll
    for (int i = 0; i < 4; ++i) O[row * DM + threadIdx.x + 256 * i] = v[i] * r * g[threadIdx.x + 256 * i];
}
__global__ void __launch_bounds__(256) resid_rms(const float* X, const float* __restrict__ Y, const float* __restrict__ g, float f, float* Hout) {
    __shared__ float red[4];
    const size_t row = blockIdx.x;
    float v[4], s = 0.f;
#pragma unroll
    for (int i = 0; i < 4; ++i) { v[i] = Y[row * DM + threadIdx.x + 256 * i]; s += v[i] * v[i]; }
    s = block_sum_256(s, red);
    const float r = rsqrtf(s * (1.0f / DM) + EPS);
#pragma unroll
    for (int i = 0; i < 4; ++i) { const size_t o = row * DM + threadIdx.x + 256 * i; Hout[o] = X[o] + f * (v[i] * r * g[threadIdx.x + 256 * i]); }
}
__global__ void swiglu_act(float* __restrict__ G, const float* __restrict__ U, size_t n) {
    const size_t i = (size_t)blockIdx.x * blockDim.x + threadIdx.x;
    if (i < n) G[i] = siluf_(G[i]) * U[i];
}

__global__ void conva_glu(const float* __restrict__ P, float* __restrict__ AG) {
    const size_t i = (size_t)blockIdx.x * blockDim.x + threadIdx.x;
    if (i >= (size_t)MT * CA) return;
    const size_t row = i / CA; const int c = (int)(i % CA);
    AG[i] = P[row * N_IN + OFF_A + c] * sigmoidf_(P[row * N_IN + OFF_A + CA + c]);
}
__global__ void __launch_bounds__(256) conva_main(const float* __restrict__ AG, const float* __restrict__ st_a  , const float* __restrict__ cw  ,
                                                  const float* __restrict__ cb, const float* __restrict__ lg, const float* __restrict__ lb, float* __restrict__ MIX,
                                                  float* __restrict__ out_pca  , float* __restrict__ out_sca  ) {
    __shared__ float red[4];
    const int row = blockIdx.x, c = threadIdx.x;
    float y = cb[c];
    if (row < MP) {
        const int t = row % SEQ;
        for (int j = 0; j < CW_A; ++j) { const int tt = t - 30 + j; if (tt >= 0) y += AG[(size_t)(row - 30 + j) * CA + c] * cw[j * CA + c]; }
        if (t >= SEQ - 30) out_pca[((size_t)(row / SEQ) * 30 + (t - (SEQ - 30))) * CA + c] = AG[(size_t)row * CA + c];
    } else {
        const int b = row - MP;
        for (int j = 0; j < 30; ++j) y += st_a[((size_t)b * 30 + j) * CA + c] * cw[j * CA + c];
        const float an = AG[(size_t)row * CA + c];
        y += an * cw[30 * CA + c];
        for (int j = 0; j < 29; ++j) out_sca[((size_t)b * 30 + j) * CA + c] = st_a[((size_t)b * 30 + j + 1) * CA + c];
        out_sca[((size_t)b * 30 + 29) * CA + c] = an;
    }
    const float mu = block_sum_256(y, red) * (1.0f / CA);
    const float d = y - mu;
    const float var = block_sum_256(d * d, red) * (1.0f / CA);
    const float z = d * rsqrtf(var + EPS) * lg[c] + lb[c];
    MIX[(size_t)row * DM + 0 + c] = siluf_(z);
}

__global__ void convc_main(const float* __restrict__ P, const float* __restrict__ st_c  , const float* __restrict__ cw  , float* __restrict__ MIX,
                           float* __restrict__ out_pcc  , float* __restrict__ out_scc  ) {
    const size_t i = (size_t)blockIdx.x * blockDim.x + threadIdx.x;
    if (i >= (size_t)MT * CC) return;
    const int row = (int)(i / CC), c = (int)(i % CC);
    const float* p = P + (size_t)row * N_IN + OFF_C;
    const float bg = p[c], z2 = p[CC + c] * p[2 * CC + c];
    float z0, z1;
    if (row < MP) {
        const int t = row % SEQ;
        z1 = (t >= 1) ? P[(size_t)(row - 1) * N_IN + OFF_C + CC + c] * P[(size_t)(row - 1) * N_IN + OFF_C + 2 * CC + c] : 0.f;
        z0 = (t >= 2) ? P[(size_t)(row - 2) * N_IN + OFF_C + CC + c] * P[(size_t)(row - 2) * N_IN + OFF_C + 2 * CC + c] : 0.f;
        if (t >= SEQ - 2) out_pcc[((size_t)(row / SEQ) * 2 + (t - (SEQ - 2))) * CC + c] = z2;
    } else {
        const int b = row - MP;
        z0 = st_c[((size_t)b * 2 + 0) * CC + c]; z1 = st_c[((size_t)b * 2 + 1) * CC + c];
        out_scc[((size_t)b * 2 + 0) * CC + c] = z1; out_scc[((size_t)b * 2 + 1) * CC + c] = z2;
    }
    MIX[(size_t)row * DM + 512 + c] = bg * (cw[0 * CC + c] * z0 + cw[1 * CC + c] * z1 + cw[2 * CC + c] * z2);
}

__global__ void gla_loga(const float* __restrict__ P, const float* __restrict__ w2  , const float* __restrict__ ba, float* __restrict__ LA) {
    const size_t i = (size_t)blockIdx.x * blockDim.x + threadIdx.x;
    if (i >= (size_t)MT * 128) return;
    const size_t row = i / 128; const int c = (int)(i % 128);
    float s = ba[c];
    for (int r = 0; r < RANK; ++r) s += P[row * N_IN + OFF_B + 768 + r] * w2[r * 128 + c];
    LA[i] = logsigmoidf_(s) * (1.0f / 16.0f);
}
__global__ void __launch_bounds__(64) gla_scan(const float* __restrict__ P, const float* __restrict__ LA, const float* __restrict__ st_g  ,
                                               float* __restrict__ ORAW  , float* __restrict__ out_pg  , float* __restrict__ out_sg  ) {
    const int chain = blockIdx.x, v = threadIdx.x;
    float S[DKB];
    int row0, nrow, h; float* so;
    if (chain < NB * HB) { const int b = chain / HB; h = chain % HB; row0 = b * SEQ; nrow = SEQ; so = out_pg + (size_t)chain * DKB * DVB;
#pragma unroll
        for (int k = 0; k < DKB; ++k) S[k] = 0.f;
    } else { const int cs = chain - NB * HB; const int b = cs / HB; h = cs % HB; row0 = MP + b; nrow = 1; so = out_sg + (size_t)cs * DKB * DVB;
#pragma unroll
        for (int k = 0; k < DKB; ++k) S[k] = st_g[(size_t)cs * DKB * DVB + k * DVB + v];
    }
    const float qs = 0.17677669529663687f;
    for (int t = 0; t < nrow; ++t) {
        const size_t row = (size_t)row0 + t;
        const float* pb = P + row * N_IN + OFF_B;
        const float vv = pb[256 + h * DVB + v];
        float o = 0.f;
#pragma unroll
        for (int k = 0; k < DKB; ++k) {
            const float a = __expf(LA[row * 128 + h * DKB + k]);
            S[k] = a * S[k] + pb[128 + h * DKB + k] * vv;
            o += (pb[h * DKB + k] * qs) * S[k];
        }
        ORAW[row * 256 + h * DVB + v] = o;
    }
#pragma unroll
    for (int k = 0; k < DKB; ++k) so[k * DVB + v] = S[k];
}
__global__ void __launch_bounds__(64) gla_out(const float* __restrict__ P, const float* __restrict__ ORAW, const float* __restrict__ ng, float* __restrict__ MIX) {
    const size_t row = blockIdx.x / HB; const int h = blockIdx.x % HB, v = threadIdx.x;
    const float o = ORAW[row * 256 + h * DVB + v];
    float s = o * o;
#pragma unroll
    for (int off = 32; off > 0; off >>= 1) s += __shfl_xor(s, off);
    const float r = rsqrtf(s * (1.0f / DVB) + EPS);
    const float g = P[row * N_IN + OFF_B + 512 + h * DVB + v];
    MIX[row * DM + 256 + h * DVB + v] = o * r * ng[h * DVB + v] * siluf_(g);
}

__global__ void fox_rows(const float* __restrict__ P, const float* __restrict__ bf, float* __restrict__ LF, float* __restrict__ out_pk, float* __restrict__ out_pv, float* __restrict__ out_plf,
                         float* __restrict__ out_sk, float* __restrict__ out_sv, float* __restrict__ out_slf) {
    const size_t i = (size_t)blockIdx.x * blockDim.x + threadIdx.x;
    if (i >= (size_t)MT * 256) return;
    const size_t row = i / 256; const int c = (int)(i % 256);
    const float* pd = P + row * N_IN + OFF_D;
    const float k = pd[256 + c], v = pd[512 + c];
    if (row < MP) { out_pk[row * 256 + c] = k; out_pv[row * 256 + c] = v; } else { out_sk[(row - MP) * 256 + c] = k; out_sv[(row - MP) * 256 + c] = v; }
    if (c < HD) { const float lf = logsigmoidf_(pd[768 + c] + bf[c]); LF[row * 4 + c] = lf; if (row < MP) out_plf[row * 4 + c] = lf; else out_slf[(row - MP) * 4 + c] = lf; }
}
__global__ void fox_cumsum(const float* __restrict__ LF, float* __restrict__ CS  ) {
    const int i = blockIdx.x * blockDim.x + threadIdx.x;
    if (i >= NB * HD) return;
    const int b = i / HD, h = i % HD; float c = 0.f;
    for (int t = 0; t < SEQ; ++t) { c += LF[((size_t)b * SEQ + t) * 4 + h]; CS[((size_t)b * SEQ + t) * 4 + h] = c; }
}
__global__ void __launch_bounds__(64) fox_prompt(const float* __restrict__ P, const float* __restrict__ CS, float* __restrict__ MIX) {
    const int row = blockIdx.x / HD, h = blockIdx.x % HD, lane = threadIdx.x;
    const int b = row / SEQ, t = row % SEQ;
    const float* pq = P + (size_t)row * N_IN + OFF_D + h * DHD;
    float q[DHD];
#pragma unroll
    for (int d = 0; d < DHD; ++d) q[d] = pq[d] * 0.125f;
    float m = -1e30f, l = 0.f, acc[DHD];
#pragma unroll
    for (int d = 0; d < DHD; ++d) acc[d] = 0.f;
    for (int s = lane; s <= t; s += 64) {
        const size_t r2 = (size_t)b * SEQ + s;
        const float* pk = P + r2 * N_IN + OFF_D + 256 + h * DHD;
        const float* pv = P + r2 * N_IN + OFF_D + 512 + h * DHD;
        float sc = 0.f;
#pragma unroll
        for (int d = 0; d < DHD; ++d) sc += q[d] * pk[d];
        sc -= CS[r2 * 4 + h];
        const float mn = fmaxf(m, sc), f = __expf(m - mn), p = __expf(sc - mn);
        l = l * f + p;
#pragma unroll
        for (int d = 0; d < DHD; ++d) acc[d] = acc[d] * f + p * pv[d];
        m = mn;
    }
    float mg = m;
#pragma unroll
    for (int off = 32; off > 0; off >>= 1) mg = fmaxf(mg, __shfl_xor(mg, off));
    const float f = __expf(m - mg);
    l *= f;
#pragma unroll
    for (int off = 32; off > 0; off >>= 1) l += __shfl_xor(l, off);
    const float il = 1.0f / l;
#pragma unroll
    for (int d = 0; d < DHD; ++d) {
        float a = acc[d] * f;
#pragma unroll
        for (int off = 32; off > 0; off >>= 1) a += __shfl_xor(a, off);
        if (lane == 0) MIX[(size_t)row * DM + 768 + h * DHD + d] = a * il;
    }
}
__global__ void fox_tail(const float* __restrict__ clf  , const int* __restrict__ pt, float* __restrict__ TAIL  ) {
    const int i = blockIdx.x * blockDim.x + threadIdx.x;
    if (i >= DB * HD) return;
    const int b = i / HD, h = i % HD; float c = 0.f;
    for (int s = PAST - 1; s >= 0; --s) {
        TAIL[((size_t)b * HD + h) * PAST + s] = c;
        const int pg = pt[b * NPAGES + s / PAGE];
        c += clf[((size_t)pg * PAGE + (s % PAGE)) * HD + h];
    }
}
__global__ void __launch_bounds__(64) fox_decode(const float* __restrict__ P, const float* __restrict__ LF, const float* __restrict__ ck, const float* __restrict__ cv, const int* __restrict__ pt,
                                                 const float* __restrict__ TAIL, float* __restrict__ MIX) {
    const int b = blockIdx.x / HD, h = blockIdx.x % HD, lane = threadIdx.x;
    const size_t row = (size_t)MP + b;
    const float* pq = P + row * N_IN + OFF_D + h * DHD;
    float q[DHD];
#pragma unroll
    for (int d = 0; d < DHD; ++d) q[d] = pq[d] * 0.125f;
    const float cnew = LF[row * 4 + h];
    float m = -1e30f, l = 0.f, acc[DHD];
#pragma unroll
    for (int d = 0; d < DHD; ++d) acc[d] = 0.f;
    for (int s = lane; s < PAST + 1; s += 64) {
        const float* pk; const float* pv; float bias;
        if (s < PAST) { const int pg = pt[b * NPAGES + s / PAGE]; const size_t o = (((size_t)pg * PAGE + (s % PAGE)) * HD + h) * DHD; pk = ck + o; pv = cv + o; bias = cnew + TAIL[((size_t)b * HD + h) * PAST + s]; }
        else { pk = P + row * N_IN + OFF_D + 256 + h * DHD; pv = P + row * N_IN + OFF_D + 512 + h * DHD; bias = 0.f; }
        float sc = 0.f;
#pragma unroll
        for (int d = 0; d < DHD; ++d) sc += q[d] * pk[d];
        sc += bias;
        const float mn = fmaxf(m, sc), f = __expf(m - mn), p = __expf(sc - mn);
        l = l * f + p;
#pragma unroll
        for (int d = 0; d < DHD; ++d) acc[d] = acc[d] * f + p * pv[d];
        m = mn;
    }
    float mg = m;
#pragma unroll
    for (int off = 32; off > 0; off >>= 1) mg = fmaxf(mg, __shfl_xor(mg, off));
    const float f = __expf(m - mg);
    l *= f;
#pragma unroll
    for (int off = 32; off > 0; off >>= 1) l += __shfl_xor(l, off);
    const float il = 1.0f / l;
#pragma unroll
    for (int d = 0; d < DHD; ++d) {
        float a = acc[d] * f;
#pragma unroll
        for (int off = 32; off > 0; off >>= 1) a += __shfl_xor(a, off);
        if (lane == 0) MIX[row * DM + 768 + h * DHD + d] = a * il;
    }
}

extern "C" void kernel_launch(void* const* d_in, const int* in_sizes, int n_in, void* d_out, int out_size, void* d_ws, size_t ws_size, hipStream_t stream) {
    const float* x_prompt = (const float*)d_in[0]; const float* x_sample = (const float*)d_in[1];
    const float* st_a = (const float*)d_in[2]; const float* st_g = (const float*)d_in[3]; const float* st_c = (const float*)d_in[4];
    const float* cache_k = (const float*)d_in[5]; const float* cache_v = (const float*)d_in[6]; const float* cache_lf = (const float*)d_in[7];
    const int* page_table = (const int*)d_in[8];
    const float* f1_pre = (const float*)d_in[9]; const float* f1_post = (const float*)d_in[10]; const float* f1_wg = (const float*)d_in[11]; const float* f1_wu = (const float*)d_in[12]; const float* f1_wd = (const float*)d_in[13];
    const float* m_pre = (const float*)d_in[14]; const float* m_post = (const float*)d_in[15]; const float* w_in = (const float*)d_in[16]; const float* w_out = (const float*)d_in[17];
    const float* a_cw = (const float*)d_in[18]; const float* a_cb = (const float*)d_in[19]; const float* a_lg = (const float*)d_in[20]; const float* a_lb = (const float*)d_in[21];
    const float* b_w2 = (const float*)d_in[22]; const float* b_ba = (const float*)d_in[23]; const float* b_ng = (const float*)d_in[24]; const float* c_cw = (const float*)d_in[25]; const float* d_bf = (const float*)d_in[26];
    const float* f2_pre = (const float*)d_in[27]; const float* f2_post = (const float*)d_in[28]; const float* f2_wg = (const float*)d_in[29]; const float* f2_wu = (const float*)d_in[30]; const float* f2_wd = (const float*)d_in[31];
    float* out = (float*)d_out;
    float* ws = (float*)d_ws;
    size_t o = 0;
    float* X = ws + o; o += (size_t)MT * DM;
    float* XN = ws + o; o += (size_t)MT * DM;
    float* G = ws + o; o += (size_t)MT * DFF;
    float* U = ws + o; o += (size_t)MT * DFF;
    float* Y = ws + o; o += (size_t)MT * DM;
    float* P = ws + o; o += (size_t)MT * N_IN;
    float* MIX = ws + o; o += (size_t)MT * DM;
    float* AG = ws + o; o += (size_t)MT * CA;
    float* LA = ws + o; o += (size_t)MT * 128;
    float* ORAW = ws + o; o += (size_t)MT * 256;
    float* LF = ws + o; o += (size_t)MT * 4;
    float* CS = ws + o; o += (size_t)MP * 4;
    float* TAIL = ws + o; o += (size_t)DB * HD * PAST;

    hipMemcpyAsync(X, x_prompt, (size_t)MP * DM * 4, hipMemcpyDeviceToDevice, stream);
    hipMemcpyAsync(X + (size_t)MP * DM, x_sample, (size_t)MS * DM * 4, hipMemcpyDeviceToDevice, stream);

    auto gemm = [&](const float* A, int lda, const float* B, int ldb, float* C, int ldc, int M, int N, int K) {
        dim3 grid((N + 63) / 64, M / 64);
        gemm_f32<<<grid, 256, 0, stream>>>(A, lda, B, ldb, C, ldc, M, N, K);
    };
    auto ffn = [&](const float* pre, const float* post, const float* wg, const float* wu, const float* wd) {
        rmsnorm_rows<<<MT, 256, 0, stream>>>(X, pre, XN);
        gemm(XN, DM, wg, DFF, G, DFF, MT, DFF, DM);
        gemm(XN, DM, wu, DFF, U, DFF, MT, DFF, DM);
        const size_t n = (size_t)MT * DFF;
        swiglu_act<<<(unsigned)((n + 255) / 256), 256, 0, stream>>>(G, U, n);
        gemm(G, DFF, wd, DM, Y, DM, MT, DM, DFF);
        resid_rms<<<MT, 256, 0, stream>>>(X, Y, post, 0.5f, X);
    };
    for (int l = 0; l < DEPTH; ++l) {
        ffn(f1_pre + (size_t)l * DM, f1_post + (size_t)l * DM, f1_wg + (size_t)l * DM * DFF, f1_wu + (size_t)l * DM * DFF, f1_wd + (size_t)l * DFF * DM);
        rmsnorm_rows<<<MT, 256, 0, stream>>>(X, m_pre + (size_t)l * DM, XN);
        gemm(XN, DM, w_in + (size_t)l * DM * N_IN, N_IN, P, N_IN, MT, N_IN, DM);
        { const size_t n = (size_t)MT * CA; conva_glu<<<(unsigned)((n + 255) / 256), 256, 0, stream>>>(P, AG); }
        conva_main<<<MT, 256, 0, stream>>>(AG, st_a + (size_t)l * DB * 30 * CA, a_cw + (size_t)l * CW_A * CA, a_cb + (size_t)l * CA, a_lg + (size_t)l * CA, a_lb + (size_t)l * CA, MIX,
                                           out + O_PCA + (size_t)l * NB * 30 * CA, out + O_SCA + (size_t)l * DB * 30 * CA);
        { const size_t n = (size_t)MT * CC; convc_main<<<(unsigned)((n + 255) / 256), 256, 0, stream>>>(P, st_c + (size_t)l * DB * 2 * CC, c_cw + (size_t)l * 3 * CC, MIX,
                                           out + O_PCC + (size_t)l * NB * 2 * CC, out + O_SCC + (size_t)l * DB * 2 * CC); }
        { const size_t n = (size_t)MT * 128; gla_loga<<<(unsigned)((n + 255) / 256), 256, 0, stream>>>(P, b_w2 + (size_t)l * RANK * 128, b_ba + (size_t)l * 128, LA); }
        gla_scan<<<(NB + DB) * HB, 64, 0, stream>>>(P, LA, st_g + (size_t)l * DB * HB * DKB * DVB, ORAW, out + O_PGLA + (size_t)l * NB * HB * DKB * DVB, out + O_SGLA + (size_t)l * DB * HB * DKB * DVB);
        gla_out<<<MT * HB, 64, 0, stream>>>(P, ORAW, b_ng + (size_t)l * 256, MIX);
        { const size_t n = (size_t)MT * 256; fox_rows<<<(unsigned)((n + 255) / 256), 256, 0, stream>>>(P, d_bf + (size_t)l * HD, LF, out + O_PK + (size_t)l * MP * 256, out + O_PV + (size_t)l * MP * 256,
                                           out + O_PLF + (size_t)l * MP * 4, out + O_SK + (size_t)l * DB * 256, out + O_SV + (size_t)l * DB * 256, out + O_SLF + (size_t)l * DB * 4); }
        fox_cumsum<<<1, 64, 0, stream>>>(LF, CS);
        fox_prompt<<<MP * HD, 64, 0, stream>>>(P, CS, MIX);
        fox_tail<<<(DB * HD + 63) / 64, 64, 0, stream>>>(cache_lf + (size_t)l * NPOOL * PAGE * HD, page_table, TAIL);
        fox_decode<<<DB * HD, 64, 0, stream>>>(P, LF, cache_k + (size_t)l * NPOOL * PAGE * HD * DHD, cache_v + (size_t)l * NPOOL * PAGE * HD * DHD, page_table, TAIL, MIX);
        gemm(MIX, DM, w_out + (size_t)l * DM * DM, DM, Y, DM, MT, DM, DM);
        resid_rms<<<MT, 256, 0, stream>>>(X, Y, m_post + (size_t)l * DM, 1.0f, X);
        ffn(f2_pre + (size_t)l * DM, f2_post + (size_t)l * DM, f2_wg + (size_t)l * DM * DFF, f2_wu + (size_t)l * DM * DFF, f2_wd + (size_t)l * DFF * DM);
    }
    hipMemcpyAsync(out + O_YP, X, (size_t)MP * DM * 4, hipMemcpyDeviceToDevice, stream);
    hipMemcpyAsync(out + O_YS, X + (size_t)MP * DM, (size_t)MS * DM * 4, hipMemcpyDeviceToDevice, stream);
}
```
